# Optimizing an MI355X kernel written in HIP

```python
import jax, jax.numpy as jnp
from jax import lax
import numpy as np

D_MODEL = 1024
BATCH = 16
SEQ = 2048
DEPTH = 1

EPS = 1e-6
A_GROUPS = 8
A_GROUP_DIM = D_MODEL // A_GROUPS
A_WIDTH = A_GROUPS * A_GROUP_DIM
CHUNK = 128
MLA_HEADS = 8
QK_NOPE_DIM = 128
QK_ROPE_DIM = 64
QK_HEAD_DIM = QK_NOPE_DIM + QK_ROPE_DIM
V_HEAD_DIM = D_MODEL // MLA_HEADS
Q_LORA_RANK = 256
KV_LORA_RANK = 128
ROPE_THETA = 10000.0
Q_BLOCK = 128
D_FF = 2816
CONV_WIDTH = 3

IN_DIM = 2 * A_WIDTH + Q_LORA_RANK + KV_LORA_RANK + QK_ROPE_DIM + 2 * D_MODEL
SPLIT_U = A_WIDTH
SPLIT_V = SPLIT_U + A_WIDTH
SPLIT_CQ = SPLIT_V + Q_LORA_RANK
SPLIT_CKV = SPLIT_CQ + KV_LORA_RANK
SPLIT_KR = SPLIT_CKV + QK_ROPE_DIM
SPLIT_GA = SPLIT_KR + D_MODEL

kernel_name = "hybrid_gmlp_mla_convffn"


def rms_norm(x, g):
    xf = x.astype(jnp.float32)
    xf = xf * lax.rsqrt(jnp.mean(jnp.square(xf), axis=-1, keepdims=True) + EPS)
    return xf.astype(x.dtype) * g


def layer_norm(x, g, b):
    xf = x.astype(jnp.float32)
    mu = jnp.mean(xf, axis=-1, keepdims=True)
    var = jnp.mean(jnp.square(xf - mu), axis=-1, keepdims=True)
    return ((xf - mu) * lax.rsqrt(var + EPS)).astype(x.dtype) * g + b


def rope_cos_sin(positions):
    inv_freq = 1.0 / (ROPE_THETA ** (jnp.arange(0, QK_ROPE_DIM, 2, dtype=jnp.float32) / QK_ROPE_DIM))
    ang = positions.astype(jnp.float32)[..., None] * inv_freq
    return jnp.cos(ang), jnp.sin(ang)


def apply_rope(x, cos, sin):
    x1, x2 = jnp.split(x.astype(jnp.float32), 2, axis=-1)
    return jnp.concatenate([x1 * cos - x2 * sin, x1 * sin + x2 * cos], axis=-1).astype(x.dtype)


def chunked_spatial_gating(u, v, v_g, v_b, w_s, b_s):
    B, S, _ = v.shape
    n_chunks = S // CHUNK
    v = layer_norm(v, v_g, v_b)
    vc = v.reshape(B, n_chunks, CHUNK, A_GROUPS, A_GROUP_DIM)
    causal = jnp.tril(jnp.ones((CHUNK, CHUNK), dtype=bool))
    w = jnp.where(causal[None], w_s, 0.0).astype(vc.dtype)
    mixed = jnp.einsum('gts,bnsgc->bntgc', w, vc) + b_s.T[None, None, :, :, None]
    return u * mixed.reshape(B, S, A_WIDTH)


def latent_attention(c_q, c_kv, k_rope, cos, sin, q_norm_g, w_uq, kv_norm_g, w_ukv):
    B, S, _ = c_q.shape
    q = (rms_norm(c_q, q_norm_g) @ w_uq).reshape(B, S, MLA_HEADS, QK_HEAD_DIM)
    q_nope, q_rope = jnp.split(q, [QK_NOPE_DIM], axis=-1)
    q_rope = apply_rope(q_rope, cos[:, :, None, :], sin[:, :, None, :])
    kv = (rms_norm(c_kv, kv_norm_g) @ w_ukv).reshape(B, S, MLA_HEADS, QK_NOPE_DIM + V_HEAD_DIM)
    k_nope, v = jnp.split(kv, [QK_NOPE_DIM], axis=-1)
    k_rope = apply_rope(k_rope, cos, sin)
    scale = QK_HEAD_DIM ** -0.5
    n_blocks = S // Q_BLOCK
    qn_blocks = q_nope.reshape(B, n_blocks, Q_BLOCK, MLA_HEADS, QK_NOPE_DIM).transpose(1, 0, 2, 3, 4)
    qr_blocks = q_rope.reshape(B, n_blocks, Q_BLOCK, MLA_HEADS, QK_ROPE_DIM).transpose(1, 0, 2, 3, 4)
    key_pos = jnp.arange(S)

    def one_block(args):
        qn, qr, i = args
        s = jnp.einsum('bqhd,bkhd->bhqk', qn, k_nope) + jnp.einsum('bqhr,bkr->bhqk', qr, k_rope)
        s = s.astype(jnp.float32) * scale
        q_pos = i * Q_BLOCK + jnp.arange(Q_BLOCK)
        s = jnp.where(key_pos[None, :] <= q_pos[:, None], s, -jnp.inf)
        p = jax.nn.softmax(s, axis=-1).astype(v.dtype)
        return jnp.einsum('bhqk,bkhd->bqhd', p, v)

    out = lax.map(one_block, (qn_blocks, qr_blocks, jnp.arange(n_blocks)))
    return out.transpose(1, 0, 2, 3, 4).reshape(B, S, MLA_HEADS * V_HEAD_DIM)


def causal_depthwise_conv(x, w, b):
    S = x.shape[1]
    xp = jnp.pad(x, ((0, 0), (CONV_WIDTH - 1, 0), (0, 0)))
    return b + sum(w[k] * xp[:, k:k + S] for k in range(CONV_WIDTH))


def conv_gated_ffn(h, w_up, conv_w, conv_b, w_down):
    up = causal_depthwise_conv(h @ w_up, conv_w, conv_b)
    gate, val = jnp.split(up, 2, axis=-1)
    return (jax.nn.silu(gate) * val) @ w_down


def setup_inputs(seed: int = 0) -> dict:
    key = jax.random.key(seed)
    ks = jax.random.split(key, 20)
    f32 = jnp.float32

    def nrm(k, shape, fan_in):
        return jax.random.normal(k, shape, f32) * (fan_in ** -0.5)

    def gain(k, shape):
        return 1.0 + 0.02 * jax.random.normal(k, shape, f32)

    x = jax.random.normal(ks[0], (BATCH, SEQ, D_MODEL), f32)
    offset = jax.random.randint(ks[1], (BATCH, 1), 0, 1024, dtype=jnp.int32)
    positions = jnp.arange(SEQ, dtype=jnp.int32)[None, :] + offset
    return {
        "x": x,
        "positions": positions,
        "mix_norm": gain(ks[2], (DEPTH, D_MODEL)),
        "w_in": nrm(ks[3], (DEPTH, D_MODEL, IN_DIM), D_MODEL),
        "a_v_norm_g": gain(ks[4], (DEPTH, A_WIDTH)),
        "a_v_norm_b": 0.02 * jax.random.normal(ks[5], (DEPTH, A_WIDTH), f32),
        "a_spatial_w": nrm(ks[6], (DEPTH, A_GROUPS, CHUNK, CHUNK), CHUNK),
        "a_spatial_b": gain(ks[7], (DEPTH, A_GROUPS, CHUNK)),
        "q_a_norm": gain(ks[8], (DEPTH, Q_LORA_RANK)),
        "w_uq": nrm(ks[9], (DEPTH, Q_LORA_RANK, MLA_HEADS * QK_HEAD_DIM), Q_LORA_RANK),
        "kv_a_norm": gain(ks[10], (DEPTH, KV_LORA_RANK)),
        "w_ukv": nrm(ks[11], (DEPTH, KV_LORA_RANK, MLA_HEADS * (QK_NOPE_DIM + V_HEAD_DIM)), KV_LORA_RANK),
        "w_out": nrm(ks[12], (DEPTH, D_MODEL, D_MODEL), D_MODEL),
        "ffn_norm": gain(ks[13], (DEPTH, D_MODEL)),
        "w_up": nrm(ks[14], (DEPTH, D_MODEL, 2 * D_FF), D_MODEL),
        "conv_w": nrm(ks[15], (DEPTH, CONV_WIDTH, 2 * D_FF), CONV_WIDTH),
        "conv_b": 0.02 * jax.random.normal(ks[16], (DEPTH, 2 * D_FF), f32),
        "w_down": nrm(ks[17], (DEPTH, D_FF, D_MODEL), D_FF),
        "final_norm": gain(ks[18], (D_MODEL,)),
    }


def reference(x, positions, mix_norm, w_in, a_v_norm_g, a_v_norm_b, a_spatial_w, a_spatial_b,
              q_a_norm, w_uq, kv_a_norm, w_ukv, w_out, ffn_norm, w_up, conv_w, conv_b, w_down,
              final_norm):
    cos, sin = rope_cos_sin(positions)
    for l in range(DEPTH):
        h = rms_norm(x, mix_norm[l])
        z = h @ w_in[l]
        u_a, v_a, c_q, c_kv, k_rope, g_a, g_b = jnp.split(
            z, [SPLIT_U, SPLIT_V, SPLIT_CQ, SPLIT_CKV, SPLIT_KR, SPLIT_GA], axis=-1)
        y_a = chunked_spatial_gating(jax.nn.gelu(u_a), jax.nn.gelu(v_a), a_v_norm_g[l], a_v_norm_b[l],
                                     a_spatial_w[l], a_spatial_b[l])
        y_b = latent_attention(c_q, c_kv, k_rope, cos, sin, q_a_norm[l], w_uq[l],
                               kv_a_norm[l], w_ukv[l])
        merged = jax.nn.sigmoid(g_a) * y_a + jax.nn.sigmoid(g_b) * y_b
        x = x + merged @ w_out[l]
        x = x + conv_gated_ffn(rms_norm(x, ffn_norm[l]), w_up[l], conv_w[l], conv_b[l], w_down[l])
    return rms_norm(x, final_norm)
```

```cpp
#include <hip/hip_runtime.h>
#include <hip/hip_cooperative_groups.h>
#include <cstdio>
#include <cstdint>
namespace cg = cooperative_groups;
namespace pg8 {
#define PG8_LAS __attribute__((address_space(3)))
typedef unsigned short bf16_t;
typedef short bf16x8 __attribute__((ext_vector_type(8)));
typedef float f32x4 __attribute__((ext_vector_type(4)));
typedef unsigned u32x4 __attribute__((ext_vector_type(4)));
constexpr int BM = 256, BK = 64, HALF = 128, HTB = HALF * BK * 2  , STAGE_BYTES = 8 * HTB, NXCD = 8, WGM = 8;

__host__ __device__ __forceinline__ int lds_byte(int r, int c) { const int st = (r >> 4) * 2 + (c >> 5), rr = r & 15, cc = c & 31, ob = rr * 64 + cc * 2; return st * 1024 + (ob ^ (((ob >> 9) & 1) << 5)); }
__host__ __device__ __forceinline__ void stage_rc(int b, int& R, int& C) { const int st = b / 1024, sb = b % 1024, swz = sb ^ (((sb >> 9) & 1) << 5); R = (st >> 1) * 16 + swz / 64; C = (st & 1) * 32 + (swz % 64) / 2; }
__host__ __device__ __forceinline__ int perm32(int rho) { const int n = rho >> 4, i = rho & 15; return 8 * (i >> 2) + 4 * n + (i & 3); }

struct Unit { int pm, pn; };
struct Gemm { const bf16_t* A; const bf16_t* Bt; };

struct StaticOrder {
    int nM, nN, nwg, G, c;
    __host__ __device__ void init(int M, int N, int G_, int c_) { nM = M / BM; nN = N / BM; nwg = nM * nN; G = G_; c = c_; }
    __host__ __device__ bool next(int i, Unit& u) const {
        const long L = (long)i * G + c; if (L >= nwg) return false;
        int wgid = (int)L; { const int q = nwg / NXCD, r = nwg % NXCD, xcd = wgid % NXCD, off = wgid / NXCD; wgid = (xcd < r ? xcd * (q + 1) : r * (q + 1) + (xcd - r) * q) + off; }
        const int nig = WGM * nN, gid = wgid / nig, fm = gid * WGM, gsz = (nM - fm) < WGM ? (nM - fm) : WGM;
        u.pm = fm + ((wgid % nig) % gsz); u.pn = (wgid % nig) / gsz; return true;
    }
    __device__ __forceinline__ void a_ready(const Unit&) const {}
    __device__ __forceinline__ void done(const Unit&) const {}
};

__device__ __forceinline__ unsigned cvt_pk_bf16(float lo, float hi) { unsigned r; asm volatile("v_cvt_pk_bf16_f32 %0, %1, %2" : "=v"(r) : "v"(lo), "v"(hi)); return r; }

template <class Epi, class Sched, bool ALIGN_EPI, bool SP2, int LDA, int LDB, int KPAIRA, int KK>
__device__ __forceinline__ void gemm_phase(PG8_LAS unsigned char* lds, const Gemm g, const Sched& S, const Epi& E, const int wave_s) {
    int lane_; asm volatile("v_mbcnt_lo_u32_b32 %0, -1, 0\n\tv_mbcnt_hi_u32_b32 %0, -1, %0" : "=v"(lane_)); const int tid_ = wave_s * 64 + lane_;
    const int tid = tid_, wid = __builtin_amdgcn_readfirstlane(tid >> 6), lane = tid & 63, wr = wid >> 2, wc = wid & 3, fr = lane & 15, fq = lane >> 4;
    constexpr int K = KK, nt = K / BK;
    unsigned voffA[2], voffB[2];
#pragma unroll
    for (int i = 0; i < 2; ++i) { int R, C; stage_rc(tid * 16 + i * 8192, R, C); const int Rb = Epi::PERM ? ((R & ~31) + perm32(R & 31)) : R;
        voffA[i] = (unsigned)(R * LDA + C) * 2u; voffB[i] = (unsigned)(Rb * LDB + C) * 2u; }
    const size_t kstep = (size_t)(BK * 2);
    const size_t hstepA = (size_t)HALF * LDA * 2, hstepB = (size_t)HALF * LDB * 2;
    const size_t kpairA = (size_t)KPAIRA;
    const size_t tstepA = 2 * hstepA, tstepB = 2 * hstepB;
    const unsigned ldsw = (unsigned)wid * 1024u;
    const int aoff = lds_byte(wr * 64 + fr, fq * 8), boff = lds_byte(wc * 32 + fr, fq * 8);
#define PG8_SA(b, h) (((b) * 2 + (h)) * HTB)
#define PG8_SB(b, h) ((4 + (b) * 2 + (h)) * HTB)
#define PG8_STAGE(bufoff, gbase, voff) do { _Pragma("unroll") for (int _i = 0; _i < 2; ++_i) \
        __builtin_amdgcn_global_load_lds((const unsigned*)((const char*)(gbase) + (voff)[_i]), (PG8_LAS unsigned*)(lds + (bufoff) + ldsw + _i * 8192), 16, 0, 0); } while (0)
#define PG8_LDA(dst, b, h) do { _Pragma("unroll") for (int m = 0; m < 4; ++m) _Pragma("unroll") for (int k = 0; k < 2; ++k) dst[m][k] = *(const PG8_LAS bf16x8*)(lds + PG8_SA(b, h) + aoff + m * 2048 + k * 1024); } while (0)
#define PG8_LDB(dst, b, h) do { _Pragma("unroll") for (int n = 0; n < 2; ++n) _Pragma("unroll") for (int k = 0; k < 2; ++k) dst[n][k] = *(const PG8_LAS bf16x8*)(lds + PG8_SB(b, h) + boff + n * 2048 + k * 1024); } while (0)
#define PG8_MMA(ai, bj, At, Bt) do { __builtin_amdgcn_s_setprio(1); _Pragma("unroll") for (int m = 0; m < 4; ++m) _Pragma("unroll") for (int n = 0; n < 2; ++n) _Pragma("unroll") for (int k = 0; k < 2; ++k) \
        acc[ai][bj][m][n] = __builtin_amdgcn_mfma_f32_16x16x32_bf16(Bt[n][k], At[m][k], acc[ai][bj][m][n], 0, 0, 0); __builtin_amdgcn_s_setprio(0); } while (0)
#define PG8_WAIT_V(n) asm volatile("s_waitcnt vmcnt(" #n ")" ::: "memory")
#define PG8_WAIT_L(n) asm volatile("s_waitcnt lgkmcnt(" #n ")" ::: "memory")
#define PG8_BAR __builtin_amdgcn_s_barrier()
#define PG8_SCHED __builtin_amdgcn_sched_barrier(0)
    Unit cur, nxt; int ui = 0;
    if (!S.next(0, cur)) return;
    f32x4 acc[2][2][4][2];
#pragma unroll
    for (int a = 0; a < 2; ++a)
#pragma unroll
        for (int b = 0; b < 2; ++b)
#pragma unroll
            for (int m = 0; m < 4; ++m)
#pragma unroll
                for (int n = 0; n < 2; ++n) acc[a][b][m][n] = (f32x4){0.f, 0.f, 0.f, 0.f};
    bf16x8 At[4][2], B0[2][2], B1[2][2];
    const char* cA = (const char*)g.A + (size_t)cur.pm * tstepA; const char* cB = (const char*)g.Bt + (size_t)cur.pn * tstepB;
    S.a_ready(cur);
    if constexpr (SP2) {
        PG8_STAGE(PG8_SB(0, 0), cB, voffB); PG8_STAGE(PG8_SB(0, 1), cB + hstepB, voffB); PG8_STAGE(PG8_SA(0, 0), cA, voffA); PG8_STAGE(PG8_SA(0, 1), cA + hstepA, voffA);
        if (wr == 1) PG8_BAR;
        PG8_WAIT_V(2); PG8_BAR;
        PG8_STAGE(PG8_SB(1, 0), cB + kstep, voffB); PG8_STAGE(PG8_SA(1, 0), cA + kstep, voffA); PG8_STAGE(PG8_SB(1, 1), cB + hstepB + kstep, voffB);
        PG8_WAIT_V(6); PG8_BAR;
    } else {
        PG8_STAGE(PG8_SB(0, 0), cB, voffB); PG8_STAGE(PG8_SA(0, 0), cA, voffA); PG8_STAGE(PG8_SB(0, 1), cB + hstepB, voffB); PG8_STAGE(PG8_SA(0, 1), cA + hstepA, voffA);
        if (wr == 1) PG8_BAR;
        PG8_WAIT_V(4); PG8_BAR;
        PG8_STAGE(PG8_SB(1, 0), cB + kstep, voffB); PG8_STAGE(PG8_SA(1, 0), cA + kstep, voffA); PG8_STAGE(PG8_SB(1, 1), cB + hstepB + kstep, voffB);
        PG8_WAIT_V(6); PG8_BAR;
    }
    for (;;) {
        const bool has_next = S.next(ui + 1, nxt);
        const char* nA = has_next ? (const char*)g.A + (size_t)nxt.pm * tstepA : cA; const char* nB = has_next ? (const char*)g.Bt + (size_t)nxt.pn * tstepB : cB;
        for (int t = 0; t < nt; t += 2) {
            const bool last = (t == nt - 2);
            const char* a1 = cA + (size_t)(t >> 1) * kpairA + kstep;
            const char* a2 = last ? nA : cA + (size_t)((t >> 1) + 1) * kpairA; const char* b2 = last ? nB : cB + (size_t)(t + 2) * kstep;
            const char* a3 = a2 + kstep; const char* b3 = b2 + kstep;
            if (last && has_next) S.a_ready(nxt);
            if constexpr (SP2) {
            PG8_LDB(B0, 0, 0); PG8_LDB(B1, 0, 1); PG8_SCHED; PG8_LDA(At, 0, 0); PG8_STAGE(PG8_SA(1, 1), a1 + hstepA, voffA);
            PG8_WAIT_V(8); PG8_WAIT_L(0); PG8_BAR; PG8_MMA(0, 0, At, B0); PG8_MMA(0, 1, At, B1); PG8_BAR; PG8_SCHED;
            PG8_LDA(At, 0, 1); PG8_STAGE(PG8_SB(0, 0), b2, voffB); PG8_STAGE(PG8_SB(0, 1), b2 + hstepB, voffB); PG8_STAGE(PG8_SA(0, 0), a2, voffA);
            PG8_WAIT_V(8); PG8_WAIT_L(0); PG8_BAR; PG8_MMA(1, 0, At, B0); PG8_MMA(1, 1, At, B1); PG8_BAR; PG8_SCHED;
            PG8_LDB(B0, 1, 0); PG8_LDB(B1, 1, 1); PG8_SCHED; PG8_LDA(At, 1, 0); PG8_STAGE(PG8_SA(0, 1), a2 + hstepA, voffA);
            PG8_WAIT_V(8); PG8_WAIT_L(0); PG8_BAR; PG8_MMA(0, 0, At, B0); PG8_MMA(0, 1, At, B1); PG8_BAR; PG8_SCHED;
            PG8_LDA(At, 1, 1); PG8_STAGE(PG8_SB(1, 0), b3, voffB); PG8_STAGE(PG8_SB(1, 1), b3 + hstepB, voffB); PG8_STAGE(PG8_SA(1, 0), a3, voffA);
            PG8_WAIT_V(8); PG8_WAIT_L(0); PG8_BAR; PG8_MMA(1, 0, At, B0); PG8_MMA(1, 1, At, B1); PG8_BAR; PG8_SCHED;
            } else {
            PG8_LDB(B0, 0, 0); PG8_SCHED; PG8_LDA(At, 0, 0); PG8_STAGE(PG8_SA(1, 1), a1 + hstepA, voffA);
            PG8_WAIT_L(8); PG8_BAR; PG8_WAIT_L(0); PG8_MMA(0, 0, At, B0); PG8_BAR; PG8_SCHED;
            PG8_LDB(B1, 0, 1); PG8_STAGE(PG8_SB(0, 0), b2, voffB);
            PG8_BAR; PG8_WAIT_L(0); PG8_MMA(0, 1, At, B1); PG8_BAR;
            PG8_LDA(At, 0, 1); PG8_STAGE(PG8_SA(0, 0), a2, voffA);
            PG8_BAR; PG8_WAIT_L(0); PG8_MMA(1, 0, At, B0); PG8_BAR; PG8_SCHED;
            PG8_STAGE(PG8_SB(0, 1), b2 + hstepB, voffB);
            PG8_WAIT_V(6); PG8_BAR; PG8_MMA(1, 1, At, B1); PG8_BAR;
            PG8_LDB(B0, 1, 0); PG8_SCHED; PG8_LDA(At, 1, 0); PG8_STAGE(PG8_SA(0, 1), a2 + hstepA, voffA);
            PG8_WAIT_L(8); PG8_BAR; PG8_WAIT_L(0); PG8_MMA(0, 0, At, B0); PG8_BAR; PG8_SCHED;
            PG8_LDB(B1, 1, 1); PG8_STAGE(PG8_SB(1, 0), b3, voffB);
            PG8_BAR; PG8_WAIT_L(0); PG8_MMA(0, 1, At, B1); PG8_BAR;
            PG8_LDA(At, 1, 1); PG8_STAGE(PG8_SA(1, 0), a3, voffA);
            PG8_BAR; PG8_WAIT_L(0); PG8_MMA(1, 0, At, B0); PG8_BAR; PG8_SCHED;
            PG8_STAGE(PG8_SB(1, 1), b3 + hstepB, voffB);
            PG8_WAIT_V(6); PG8_BAR; PG8_MMA(1, 1, At, B1); PG8_BAR;
            }
        }
        if constexpr (ALIGN_EPI) { if (wr == 0) PG8_BAR; }
        if constexpr (!Epi::AFTER_DRAIN) { E(acc, cur, wr, wc, fr, fq); S.done(cur); }
        if (!has_next) break;
#pragma unroll
        for (int a = 0; a < 2; ++a)
#pragma unroll
            for (int b = 0; b < 2; ++b)
#pragma unroll
                for (int m = 0; m < 4; ++m)
#pragma unroll
                    for (int n = 0; n < 2; ++n) acc[a][b][m][n] = (f32x4){0.f, 0.f, 0.f, 0.f};
        cur = nxt; cA = nA; cB = nB; ++ui;
        if constexpr (ALIGN_EPI) { if (wr == 1) PG8_BAR; }
    }
    PG8_WAIT_V(0);
    if constexpr (!ALIGN_EPI) { if (wr == 0) PG8_BAR; }
    PG8_BAR;
    if constexpr (Epi::AFTER_DRAIN) { E.fused(acc, cur, wr, wc, fr, fq, lds, wid, lane); S.done(cur); }
#undef PG8_SA
#undef PG8_SB
#undef PG8_STAGE
#undef PG8_LDA
#undef PG8_LDB
#undef PG8_MMA
#undef PG8_WAIT_V
#undef PG8_WAIT_L
#undef PG8_BAR
#undef PG8_SCHED
}
}


#define GAS __attribute__((address_space(1)))
#define LAS __attribute__((address_space(3)))
typedef unsigned short bf16;
typedef unsigned v4u __attribute__((ext_vector_type(4)));
typedef unsigned v2u __attribute__((ext_vector_type(2)));
typedef float f32x4 __attribute__((ext_vector_type(4)));
typedef float f32x2 __attribute__((ext_vector_type(2)));
typedef float f32x16 __attribute__((ext_vector_type(16)));
typedef short bf16x8 __attribute__((ext_vector_type(8)));
typedef short s16x4 __attribute__((ext_vector_type(4)));
#define SBAR() __builtin_amdgcn_sched_barrier(0)
#define LDS_WAIT() asm volatile("s_waitcnt lgkmcnt(0)" ::: "memory")

constexpr int T = 32768, SEQ = 2048, DM = 1024, NIN = 4608, NQ = 1536, NKV = 2048, NUP = 5632, DFF = 2816;
constexpr float EPS = 1e-6f;
constexpr float LOG2E = 1.4426950408889634f;
constexpr size_t MiB = 1u << 20;
constexpr size_t WS_WIN = 0, WS_WUQ = 9 * MiB, WS_WUKV = 10 * MiB, WS_WOUT = 11 * MiB, WS_WUP = 13 * MiB, WS_WDN = 24 * MiB, WS_WSP = 30 * MiB,
                 WS_STAT = 31 * MiB, WS_CS = 32 * MiB, WS_H = 44 * MiB, WS_U = 108 * MiB, WS_V = 172 * MiB, WS_GA = 236 * MiB, WS_GB = 300 * MiB,
                 WS_CQ = 364 * MiB, WS_CKV = 380 * MiB, WS_KR = 396 * MiB, WS_VB = 400 * MiB, WS_UP = 108 * MiB, WS_END = 464 * MiB;
constexpr int LDS_BYTES = 147456;

__device__ __forceinline__ unsigned cvtpk(float lo, float hi) { unsigned r; asm volatile("v_cvt_pk_bf16_f32 %0, %1, %2" : "=v"(r) : "v"(lo), "v"(hi)); return r; }
__device__ __forceinline__ float bflo(unsigned w) { return __uint_as_float(w << 16); }
__device__ __forceinline__ float bfhi(unsigned w) { return __uint_as_float(w & 0xffff0000u); }
__device__ __forceinline__ float sigm(float x) { return __builtin_amdgcn_rcpf(1.f + __builtin_amdgcn_exp2f(-LOG2E * x)); }
__device__ __forceinline__ float gelu_t(float x) { const float z = 0.7978845608028654f * (x + 0.044715f * x * x * x); return x * sigm(2.f * z); }
__device__ __forceinline__ int mytid(int wave_s) { int lane_; asm volatile("v_mbcnt_lo_u32_b32 %0, -1, 0\n\tv_mbcnt_hi_u32_b32 %0, -1, %0" : "=v"(lane_)); return wave_s * 64 + lane_; }
__device__ __forceinline__ float wave_sum(float v) {
#pragma unroll
    for (int o = 1; o < 64; o <<= 1) v += __shfl_xor(v, o);
    return v;
}
__device__ __forceinline__ v4u pack8(const float* v) { v4u w; w.x = cvtpk(v[0], v[1]); w.y = cvtpk(v[2], v[3]); w.z = cvtpk(v[4], v[5]); w.w = cvtpk(v[6], v[7]); return w; }
__device__ __forceinline__ void unpack8(v4u w, float* v) { v[0] = bflo(w.x); v[1] = bfhi(w.x); v[2] = bflo(w.y); v[3] = bfhi(w.y); v[4] = bflo(w.z); v[5] = bfhi(w.z); v[6] = bflo(w.w); v[7] = bfhi(w.w); }

struct Ctx {
    const float* in[19]; float* out; unsigned char* ws;
};

#define EPI_ROWS_BEGIN  _Pragma("unroll") for (int ai = 0; ai < 2; ++ai) _Pragma("unroll") for (int m = 0; m < 4; ++m) { const int row = u.pm * 256 + ai * 128 + wr * 64 + m * 16 + fr;
#define EPI_ROWS_END    }
#define EPI_V8(bj) float v[8]; { const pg8::f32x4 a0 = acc[ai][bj][m][0], a1 = acc[ai][bj][m][1]; v[0] = a0[0]; v[1] = a0[1]; v[2] = a0[2]; v[3] = a0[3]; v[4] = a1[0]; v[5] = a1[1]; v[6] = a1[2]; v[7] = a1[3]; }

struct EpiIn {
    static constexpr bool PERM = true, AFTER_DRAIN = false;
    unsigned char* ws;
    __device__ __forceinline__ void operator()(const pg8::f32x4 (&acc)[2][2][4][2], const pg8::Unit& u, int wr, int wc, int fr, int fq) const {
        bf16* U = (bf16*)(ws + WS_U); bf16* V = (bf16*)(ws + WS_V); bf16* GA = (bf16*)(ws + WS_GA); bf16* GB = (bf16*)(ws + WS_GB); bf16* CQ = (bf16*)(ws + WS_CQ); bf16* CKV = (bf16*)(ws + WS_CKV); bf16* KR = (bf16*)(ws + WS_KR);
        float* st_ = (float*)(ws + WS_STAT); float* ssq_q = st_; float* ssq_kv = st_ + T; float* vsum = st_ + 2 * T; float* vsq = st_ + 3 * T; const f32x2* cs = (const f32x2*)(ws + WS_CS);
        const int reg = u.pn >> 2;
        const int cw = wc * 32 + 8 * fq;
        if (reg == 0 || reg == 2 || reg == 3) {
            bf16* O = reg == 0 ? U : (reg == 2 ? GA : GB);
            const int cbase = (u.pn & 3) * 256 + cw;
            EPI_ROWS_BEGIN
#pragma unroll
                for (int bj = 0; bj < 2; ++bj) { EPI_V8(bj)
#pragma unroll
                    for (int j = 0; j < 8; ++j) v[j] = reg == 0 ? gelu_t(v[j]) : sigm(v[j]);
                    *(v4u*)(O + (size_t)row * DM + cbase + bj * 128) = pack8(v); }
            EPI_ROWS_END
        } else if (reg == 1) {
            const int cbase = (u.pn & 3) * 256 + cw;
            EPI_ROWS_BEGIN
                float s1 = 0.f, s2 = 0.f;
#pragma unroll
                for (int bj = 0; bj < 2; ++bj) { EPI_V8(bj)
#pragma unroll
                    for (int j = 0; j < 8; ++j) { v[j] = gelu_t(v[j]); s1 += v[j]; s2 += v[j] * v[j]; }
                    *(v4u*)(V + (size_t)row * DM + cbase + bj * 128) = pack8(v); }
                s1 += __shfl_xor(s1, 16); s1 += __shfl_xor(s1, 32); s2 += __shfl_xor(s2, 16); s2 += __shfl_xor(s2, 32);
                if (fq == 0) { atomicAdd(vsum + row, s1); atomicAdd(vsq + row, s2); }
            EPI_ROWS_END
        } else if (u.pn == 16) {
            EPI_ROWS_BEGIN
                float s2 = 0.f;
#pragma unroll
                for (int bj = 0; bj < 2; ++bj) { EPI_V8(bj)
#pragma unroll
                    for (int j = 0; j < 8; ++j) s2 += v[j] * v[j];
                    *(v4u*)(CQ + (size_t)row * 256 + cw + bj * 128) = pack8(v); }
                s2 += __shfl_xor(s2, 16); s2 += __shfl_xor(s2, 32);
                if (fq == 0) atomicAdd(ssq_q + row, s2);
            EPI_ROWS_END
        } else {
            EPI_ROWS_BEGIN
                float s2 = 0.f;
                { EPI_V8(0)
#pragma unroll
                    for (int j = 0; j < 8; ++j) s2 += v[j] * v[j];
                    *(v4u*)(CKV + (size_t)row * 256 + cw) = pack8(v); }
                s2 += __shfl_xor(s2, 16); s2 += __shfl_xor(s2, 32);
                if (fq == 0) atomicAdd(ssq_kv + row, s2);
                { EPI_V8(1)
                    *(v4u*)(CKV + (size_t)row * 256 + 128 + cw) = pack8(v);
                    if (wc < 2) {
                        const f32x2* c = cs + (size_t)row * 32 + (cw >> 1);
                        float o[8];
#pragma unroll
                        for (int j = 0; j < 4; ++j) { const f32x2 t = c[j]; o[2 * j] = v[2 * j] * t.x - v[2 * j + 1] * t.y; o[2 * j + 1] = v[2 * j] * t.y + v[2 * j + 1] * t.x; }
                        *(v4u*)(KR + (size_t)row * 64 + cw) = pack8(o);
                    } }
            EPI_ROWS_END
        }
    }
};
struct EpiQ {
    static constexpr bool PERM = true, AFTER_DRAIN = false;
    bf16* Q; unsigned char* ws;
    __device__ __forceinline__ void operator()(const pg8::f32x4 (&acc)[2][2][4][2], const pg8::Unit& u, int wr, int wc, int fr, int fq) const {
        const float* ssq_q = (const float*)(ws + WS_STAT); const f32x2* cs = (const f32x2*)(ws + WS_CS);
        EPI_ROWS_BEGIN
            const float rq = 1.0f / sqrtf(ssq_q[row] * (1.0f / 256.0f) + EPS);
#pragma unroll
            for (int bj = 0; bj < 2; ++bj) { EPI_V8(bj)
                const int col = u.pn * 256 + bj * 128 + wc * 32 + 8 * fq;
                const int hh = col / 192, within = col - hh * 192;
#pragma unroll
                for (int j = 0; j < 8; ++j) v[j] *= rq;
                if (within >= 128) {
                    const f32x2* c = cs + (size_t)row * 32 + ((within - 128) >> 1);
#pragma unroll
                    for (int j = 0; j < 4; ++j) { const f32x2 t = c[j]; const float x1 = v[2 * j], x2 = v[2 * j + 1]; v[2 * j] = x1 * t.x - x2 * t.y; v[2 * j + 1] = x1 * t.y + x2 * t.x; }
                }
                *(v4u*)(Q + (size_t)row * NQ + col) = pack8(v); }
        EPI_ROWS_END
    }
};
struct EpiKV {
    static constexpr bool PERM = true, AFTER_DRAIN = false;
    unsigned char* ws;
    __device__ __forceinline__ void operator()(const pg8::f32x4 (&acc)[2][2][4][2], const pg8::Unit& u, int wr, int wc, int fr, int fq) const {
        bf16* Kn = (bf16*)(ws + WS_H); bf16* Vb = (bf16*)(ws + WS_VB); const float* ssq_kv = (const float*)(ws + WS_STAT) + T;
        const int col = u.pn * 128 + wc * 32 + 8 * fq;
        EPI_ROWS_BEGIN
            const float rk = 1.0f / sqrtf(ssq_kv[row] * (1.0f / 128.0f) + EPS);
#pragma unroll
            for (int bj = 0; bj < 2; ++bj) { EPI_V8(bj)
#pragma unroll
                for (int j = 0; j < 8; ++j) v[j] *= rk;
                *(v4u*)((bj == 0 ? Kn : Vb) + (size_t)row * DM + col) = pack8(v); }
        EPI_ROWS_END
    }
};
struct EpiOut {
    static constexpr bool PERM = true, AFTER_DRAIN = false;
    const float* x; float* x1; unsigned char* ws;
    __device__ __forceinline__ void operator()(const pg8::f32x4 (&acc)[2][2][4][2], const pg8::Unit& u, int wr, int wc, int fr, int fq) const {
        bf16* x1b = (bf16*)(ws + WS_H); float* ss2 = (float*)(ws + WS_STAT) + 4 * T;
        const int cbase = u.pn * 256 + wc * 32 + 8 * fq;
        EPI_ROWS_BEGIN
            float s2 = 0.f;
#pragma unroll
            for (int bj = 0; bj < 2; ++bj) { EPI_V8(bj)
                const size_t off = (size_t)row * DM + cbase + bj * 128;
                const f32x4 xa = *(const f32x4*)(x + off), xb = *(const f32x4*)(x + off + 4);
                v[0] += xa[0]; v[1] += xa[1]; v[2] += xa[2]; v[3] += xa[3]; v[4] += xb[0]; v[5] += xb[1]; v[6] += xb[2]; v[7] += xb[3];
#pragma unroll
                for (int j = 0; j < 8; ++j) s2 += v[j] * v[j];
                *(f32x4*)(x1 + off) = (f32x4){v[0], v[1], v[2], v[3]}; *(f32x4*)(x1 + off + 4) = (f32x4){v[4], v[5], v[6], v[7]};
                *(v4u*)(x1b + off) = pack8(v); }
            s2 += __shfl_xor(s2, 16); s2 += __shfl_xor(s2, 32);
            if (fq == 0) atomicAdd(ss2 + row, s2);
        EPI_ROWS_END
    }
};
struct EpiUp {
    static constexpr bool PERM = true, AFTER_DRAIN = false;
    unsigned char* ws;
    __device__ __forceinline__ void operator()(const pg8::f32x4 (&acc)[2][2][4][2], const pg8::Unit& u, int wr, int wc, int fr, int fq) const {
        bf16* UP = (bf16*)(ws + WS_UP); const float* ss2 = (const float*)(ws + WS_STAT) + 4 * T;
        const int cbase = u.pn * 256 + wc * 32 + 8 * fq;
        EPI_ROWS_BEGIN
            const float r2 = 1.0f / sqrtf(ss2[row] * (1.0f / 1024.0f) + EPS);
#pragma unroll
            for (int bj = 0; bj < 2; ++bj) { EPI_V8(bj)
#pragma unroll
                for (int j = 0; j < 8; ++j) v[j] *= r2;
                *(v4u*)(UP + (size_t)row * NUP + cbase + bj * 128) = pack8(v); }
        EPI_ROWS_END
    }
};
struct EpiDown {
    static constexpr bool PERM = true, AFTER_DRAIN = false;
    float* x1; unsigned char* ws;
    __device__ __forceinline__ void operator()(const pg8::f32x4 (&acc)[2][2][4][2], const pg8::Unit& u, int wr, int wc, int fr, int fq) const {
        float* ss3 = (float*)(ws + WS_STAT) + 5 * T;
        const int cbase = u.pn * 256 + wc * 32 + 8 * fq;
        EPI_ROWS_BEGIN
            float s2 = 0.f;
#pragma unroll
            for (int bj = 0; bj < 2; ++bj) { EPI_V8(bj)
                const size_t off = (size_t)row * DM + cbase + bj * 128;
                const f32x4 xa = *(const f32x4*)(x1 + off), xb = *(const f32x4*)(x1 + off + 4);
                v[0] += xa[0]; v[1] += xa[1]; v[2] += xa[2]; v[3] += xa[3]; v[4] += xb[0]; v[5] += xb[1]; v[6] += xb[2]; v[7] += xb[3];
#pragma unroll
                for (int j = 0; j < 8; ++j) s2 += v[j] * v[j];
                *(f32x4*)(x1 + off) = (f32x4){v[0], v[1], v[2], v[3]}; *(f32x4*)(x1 + off + 4) = (f32x4){v[4], v[5], v[6], v[7]}; }
            s2 += __shfl_xor(s2, 16); s2 += __shfl_xor(s2, 32);
            if (fq == 0) atomicAdd(ss3 + row, s2);
        EPI_ROWS_END
    }
};

__device__ __forceinline__ int rowmap(int mode, int n) {
    if (mode == 1) {
        if (n < 2048) return n;
        if (n < 2304) return 4096 + (n - 2048);
        if (n < 2432) return 4352 + (n - 2304);
        if (n < 2496) { const int j = n - 2432; return 4480 + 2 * (j & 31) + (j >> 5); }
        if (n < 3520) return 2048 + (n - 2496);
        return 3072 + (n - 3520);
    } else if (mode == 2) {
        const int h = n / 192, d = n - h * 192; if (d < 128) return n; const int j = d - 128; return h * 192 + 128 + 2 * (j & 31) + (j >> 5);
    } else if (mode == 3) {
        if (n < DFF) return (n >> 7) * 256 + (n & 127);
        const int c = n - DFF; return (c >> 7) * 256 + 128 + (c & 127);
    }
    return n;
}
__device__ __forceinline__ void p0_transpose_item(const float* W, int N, bf16* WT, int ldk, const float* gain, int mode, LAS float* scr, int item, int lane) {
    const int nblk = N / 32, kb = item / nblk, nb = item - kb * nblk, k0 = 64 * kb, n0 = 32 * nb;
#pragma unroll 8
    for (int i = 0; i < 32; ++i) { const int kk = 2 * i + (lane >> 5); const float gk = gain ? gain[k0 + kk] : 1.f; scr[kk * 33 + (lane & 31)] = W[(size_t)(k0 + kk) * N + n0 + (lane & 31)] * gk; }
    LDS_WAIT(); asm volatile("" ::: "memory");
    const int c = lane & 7;
#pragma unroll
    for (int j = 0; j < 4; ++j) { const int n = (lane >> 3) + 8 * j; const LAS float* s = scr + (8 * c) * 33 + n;
        v4u o; o.x = cvtpk(s[0 * 33], s[1 * 33]); o.y = cvtpk(s[2 * 33], s[3 * 33]); o.z = cvtpk(s[4 * 33], s[5 * 33]); o.w = cvtpk(s[6 * 33], s[7 * 33]);
        *(v4u*)(WT + (size_t)rowmap(mode, n0 + n) * ldk + k0 + 8 * c) = o; }
    LDS_WAIT(); asm volatile("" ::: "memory");
}
__device__ __forceinline__ void p0_prologue(const Ctx& C, LAS unsigned char* lds, int G, const int wave_s) {
    int tid_ = mytid(wave_s); asm volatile("" : "+v"(tid_)); const int tid = tid_, lane = tid & 63, wave = tid >> 6;
    unsigned char* ws = C.ws;
    LAS float* scr = (LAS float*)(lds + wave * 16384);
    const int gw = blockIdx.x * 8 + wave, NGW = G * 8;
    constexpr int I_IN = 16 * 142, I_UQ = 4 * 48, I_UKV = 2 * 64, I_OUT = 16 * 32, I_UP = 16 * 176, I_DN = 44 * 32;
    constexpr int NITEMS = I_IN + I_UQ + I_UKV + I_OUT + I_UP + I_DN;
    for (int it = gw; it < NITEMS; it += NGW) {
        int r = it;
        if (r < I_IN) { p0_transpose_item(C.in[3], 4544, (bf16*)(ws + WS_WIN), 1024, C.in[2], 1, scr, r, lane); continue; } r -= I_IN;
        if (r < I_UQ) { p0_transpose_item(C.in[9], 1536, (bf16*)(ws + WS_WUQ), 256, C.in[8], 2, scr, r, lane); continue; } r -= I_UQ;
        if (r < I_UKV) { p0_transpose_item(C.in[11], 2048, (bf16*)(ws + WS_WUKV), 256, C.in[10], 0, scr, r, lane); continue; } r -= I_UKV;
        if (r < I_OUT) { p0_transpose_item(C.in[12], 1024, (bf16*)(ws + WS_WOUT), 1024, nullptr, 0, scr, r, lane); continue; } r -= I_OUT;
        if (r < I_UP) { p0_transpose_item(C.in[14], 5632, (bf16*)(ws + WS_WUP), 1024, C.in[13], 3, scr, r, lane); continue; } r -= I_UP;
        p0_transpose_item(C.in[17], 1024, (bf16*)(ws + WS_WDN), 2816, nullptr, 0, scr, r, lane);
    }
    const float* x = C.in[0]; bf16* H = (bf16*)(ws + WS_H);
    for (int mrow = gw; mrow < T; mrow += NGW) {
        const f32x4* xr = (const f32x4*)(x + (size_t)mrow * DM) + lane;
        f32x4 v[4]; float s = 0.f;
#pragma unroll
        for (int j = 0; j < 4; ++j) { v[j] = xr[64 * j]; s += (v[j][0] * v[j][0] + v[j][1] * v[j][1]) + (v[j][2] * v[j][2] + v[j][3] * v[j][3]); }
        const float rinv = 1.0f / sqrtf(wave_sum(s) * (1.0f / DM) + EPS);
        v2u* o8 = (v2u*)(H + (size_t)mrow * DM) + lane;
#pragma unroll
        for (int j = 0; j < 4; ++j) { v2u w; w.x = cvtpk(v[j][0] * rinv, v[j][1] * rinv); w.y = cvtpk(v[j][2] * rinv, v[j][3] * rinv); o8[64 * j] = w; }
    }
    const int gt = blockIdx.x * 512 + tid, NGT = G * 512;
    { const int* pos = (const int*)C.in[1]; f32x2* cs = (f32x2*)(ws + WS_CS);
      for (int idx = gt; idx < T * 32; idx += NGT) { const int t = idx >> 5, i = idx & 31;
          double inv = 1.0; for (int k = 0; k < i; ++k) inv *= 0.74989420933245582730;
          const double rev = (double)pos[t] * inv * 0.15915494309189533577; const float fr = (float)(rev - __builtin_rint(rev));
          cs[idx] = (f32x2){__builtin_amdgcn_cosf(fr), __builtin_amdgcn_sinf(fr)}; } }
    { v4u z = {0u, 0u, 0u, 0u};
      v4u* st = (v4u*)(ws + WS_STAT); for (int i = gt; i < 6 * T / 4; i += NGT) st[i] = z;
      v4u* wp = (v4u*)(ws + WS_WIN + (size_t)4544 * 1024 * 2); for (int i = gt; i < 64 * 1024 * 2 / 16; i += NGT) wp[i] = z;
      for (int i = gt; i < 2048 * 16; i += NGT) { const int r = i >> 4, c = i & 15; *(v4u*)(ws + WS_WUKV + (size_t)r * 512 + 256 + c * 16) = z; } }
    { const float* w = C.in[6]; bf16* wsb = (bf16*)(ws + WS_WSP);
      for (int i = gt; i < 8 * 128 * 128 / 8; i += NGT) { const int e = i * 8, s0 = e & 127, t = (e >> 7) & 127; float v[8];
          const f32x4 a = *(const f32x4*)(w + e), b = *(const f32x4*)(w + e + 4);
          v[0] = a[0]; v[1] = a[1]; v[2] = a[2]; v[3] = a[3]; v[4] = b[0]; v[5] = b[1]; v[6] = b[2]; v[7] = b[3];
#pragma unroll
          for (int j = 0; j < 8; ++j) if (s0 + j > t) v[j] = 0.f;
          *(v4u*)(wsb + e) = pack8(v); } }
}

__device__ __forceinline__ int v_st(int k, int c) { const int kk = (k & ~0xC) | ((k & 4) << 1) | ((k & 8) >> 1); return ((kk >> 3) * 4 + (c >> 5)) * 512 + ((kk & 7) * 32 + (c & 31)) * 2; }
__device__ __forceinline__ int v_rd_base(int lane) { return ((lane & 3) << 3) | (((lane >> 2) & 3) << 6) | (((lane >> 4) & 1) << 5) | (((lane >> 5) & 1) << 8); }
__device__ __forceinline__ int crow(int r, int hi) { return (r & 3) + 8 * (r >> 2) + 4 * hi; }
#define TRRD(dst, off) asm volatile("ds_read_b64_tr_b16 %0, %1 offset:%2" : "=&v"(dst) : "v"(vb), "i"(off) : "memory")
template <int OFF> __device__ __forceinline__ void pv_d0(f32x16& o, int vb, bf16x8 pa0, bf16x8 pa1, bf16x8 pa2, bf16x8 pa3) {
    s16x4 l0, l1, l2, l3, h0, h1, h2, h3;
    TRRD(l0, OFF); TRRD(h0, OFF + 2048); TRRD(l1, OFF + 4096); TRRD(h1, OFF + 6144); TRRD(l2, OFF + 8192); TRRD(h2, OFF + 10240); TRRD(l3, OFF + 12288); TRRD(h3, OFF + 14336);
    asm volatile("s_waitcnt lgkmcnt(0)" ::: "memory"); SBAR();
    o = __builtin_amdgcn_mfma_f32_32x32x16_bf16(pa0, (bf16x8){l0[0], l0[1], l0[2], l0[3], h0[0], h0[1], h0[2], h0[3]}, o, 0, 0, 0);
    o = __builtin_amdgcn_mfma_f32_32x32x16_bf16(pa1, (bf16x8){l1[0], l1[1], l1[2], l1[3], h1[0], h1[1], h1[2], h1[3]}, o, 0, 0, 0);
    o = __builtin_amdgcn_mfma_f32_32x32x16_bf16(pa2, (bf16x8){l2[0], l2[1], l2[2], l2[3], h2[0], h2[1], h2[2], h2[3]}, o, 0, 0, 0);
    o = __builtin_amdgcn_mfma_f32_32x32x16_bf16(pa3, (bf16x8){l3[0], l3[1], l3[2], l3[3], h3[0], h3[1], h3[2], h3[3]}, o, 0, 0, 0);
}

__device__ __forceinline__ void spatial_phase(const Ctx& C, LAS unsigned char* lds, int G, int vcu, const int wave_s) {
    int tid_ = mytid(wave_s); asm volatile("" : "+v"(tid_)); const int tid = tid_, lane = tid & 63, wid = __builtin_amdgcn_readfirstlane(tid >> 6), r32 = lane & 31, hi = lane >> 5;
    unsigned char* ws = C.ws;
    const bf16* Vg = (const bf16*)(ws + WS_V); bf16* U = (bf16*)(ws + WS_U); const bf16* GA = (const bf16*)(ws + WS_GA); const bf16* Wsb = (const bf16*)(ws + WS_WSP);
    const float* vsum = (const float*)(ws + WS_STAT) + 2 * T; const float* vsq = (const float*)(ws + WS_STAT) + 3 * T;
    const float* gam = C.in[4]; const float* bet = C.in[5]; const float* bsp = C.in[7];
    const int sr = tid >> 4, sc = (tid & 15) * 8;
    const int tb = wid & 3, ch = wid >> 2;
    LAS float* stg = (LAS float*)(lds + 32768);
    const int vb = (int)(uintptr_t)lds + v_rd_base(lane) + ch * 1024;
    for (int unit = vcu; unit < 2048; unit += G) {
        const int g = unit & 7, n = (unit >> 3) & 15, b = unit >> 7;
        const int row0 = b * SEQ + n * 128, col0 = g * 128;
        float gm[8], bt[8];
        { const f32x4 a = *(const f32x4*)(gam + col0 + sc), a2 = *(const f32x4*)(gam + col0 + sc + 4), c = *(const f32x4*)(bet + col0 + sc), c2 = *(const f32x4*)(bet + col0 + sc + 4);
          gm[0] = a[0]; gm[1] = a[1]; gm[2] = a[2]; gm[3] = a[3]; gm[4] = a2[0]; gm[5] = a2[1]; gm[6] = a2[2]; gm[7] = a2[3];
          bt[0] = c[0]; bt[1] = c[1]; bt[2] = c[2]; bt[3] = c[3]; bt[4] = c2[0]; bt[5] = c2[1]; bt[6] = c2[2]; bt[7] = c2[3]; }
#pragma unroll
        for (int q = 0; q < 4; ++q) {
            const int half = q >> 1, rr = (q & 1) * 32 + sr, s = half * 64 + rr, trow = row0 + s;
            const v4u raw = *(const v4u*)(Vg + (size_t)trow * DM + col0 + sc);
            const float mu = vsum[trow] * (1.0f / 1024.0f); const float var = vsq[trow] * (1.0f / 1024.0f) - mu * mu; const float rstd = 1.0f / sqrtf(var + EPS);
            float v[8]; unpack8(raw, v);
#pragma unroll
            for (int j = 0; j < 8; ++j) v[j] = (v[j] - mu) * rstd * gm[j] + bt[j];
            *(LAS v4u*)(lds + half * 16384 + v_st(rr, sc)) = pack8(v);
        }
        __syncthreads();
        f32x16 o0 = {}, o1 = {};
#pragma unroll
        for (int half = 0; half < 2; ++half) {
            if (half * 64 > tb * 32 + 31) continue;
            const bf16* wp = Wsb + ((size_t)g * 128 + tb * 32 + r32) * 128 + half * 64 + hi * 8;
            const bf16x8 pa0 = *(const bf16x8*)(wp), pa1 = *(const bf16x8*)(wp + 16), pa2 = *(const bf16x8*)(wp + 32), pa3 = *(const bf16x8*)(wp + 48);
            if (half == 0) { pv_d0<0>(o0, vb, pa0, pa1, pa2, pa3); pv_d0<512>(o1, vb, pa0, pa1, pa2, pa3); }
            else { pv_d0<16384>(o0, vb, pa0, pa1, pa2, pa3); pv_d0<16384 + 512>(o1, vb, pa0, pa1, pa2, pa3); }
        }
#pragma unroll
        for (int r = 0; r < 16; ++r) { const int t = tb * 32 + crow(r, hi); const float bs = bsp[g * 128 + t];
            stg[t * 132 + (2 * ch) * 32 + r32] = o0[r] + bs; stg[t * 132 + (2 * ch + 1) * 32 + r32] = o1[r] + bs; }
        __syncthreads();
#pragma unroll
        for (int q = 0; q < 4; ++q) { const int id = tid + 512 * q, t = id >> 4, cc = (id & 15) * 8;
            const f32x4 m0 = *(const LAS f32x4*)(stg + t * 132 + cc), m1 = *(const LAS f32x4*)(stg + t * 132 + cc + 4);
            const size_t off = (size_t)(row0 + t) * DM + col0 + cc;
            float uu[8], ga[8]; unpack8(*(const v4u*)(U + off), uu); unpack8(*(const v4u*)(GA + off), ga);
            float ov[8];
#pragma unroll
            for (int j = 0; j < 8; ++j) ov[j] = uu[j] * ga[j] * (j < 4 ? m0[j] : m1[j - 4]);
            *(v4u*)(U + off) = pack8(ov); }
        __syncthreads();
    }
}

constexpr float ATT_SCALE = 0.07216878364870322f;
#define KSW(row, colB) ((row) * 384 + ((colB) ^ (((row) & 7) << 4)))
constexpr int AT_K = 0, AT_KB = 24576, AT_V = 49152, AT_VB = 16384, AT_WS = 81920;
__device__ __forceinline__ void partialSM(f32x16& p0, f32x16& p1, float& m_reg, float& mn, float& alpha) {
    float pmax = p0[0];
#pragma unroll
    for (int r = 1; r < 16; ++r) pmax = fmaxf(pmax, p0[r]);
#pragma unroll
    for (int r = 0; r < 16; ++r) pmax = fmaxf(pmax, p1[r]);
    { auto rr = __builtin_amdgcn_permlane32_swap(__float_as_uint(pmax), __float_as_uint(pmax), false, false);
      pmax = fmaxf(__uint_as_float(rr[0]), __uint_as_float(rr[1])); }
    constexpr float C2 = LOG2E * ATT_SCALE;
    if (__builtin_expect(__all((pmax - m_reg) * ATT_SCALE <= 8.f), 1)) { mn = m_reg; alpha = 1.f; }
    else { mn = fmaxf(m_reg, pmax); alpha = __builtin_amdgcn_exp2f((m_reg - mn) * C2); m_reg = mn; }
    const float mnL = -mn * C2;
#pragma unroll
    for (int r = 0; r < 16; ++r) { p0[r] = __builtin_amdgcn_exp2f(fmaf(p0[r], C2, mnL)); p1[r] = __builtin_amdgcn_exp2f(fmaf(p1[r], C2, mnL)); }
}
__device__ __forceinline__ void finishSM(f32x16& p0, f32x16& p1, float alpha, float& l_reg, bf16x8& pa0, bf16x8& pa1, bf16x8& pa2, bf16x8& pa3) {
    float ps = 0;
#pragma unroll
    for (int r = 0; r < 16; ++r) ps += p0[r];
#pragma unroll
    for (int r = 0; r < 16; ++r) ps += p1[r];
    { auto rr = __builtin_amdgcn_permlane32_swap(__float_as_uint(ps), __float_as_uint(ps), false, false);
      ps = __uint_as_float(rr[0]) + __uint_as_float(rr[1]); }
    l_reg = l_reg * alpha + ps;
#define PK4(P, B_, OUT) do { unsigned a0 = cvtpk(P[B_+0], P[B_+1]), a1 = cvtpk(P[B_+2], P[B_+3]);                          \
        unsigned b0 = cvtpk(P[B_+4], P[B_+5]), b1 = cvtpk(P[B_+6], P[B_+7]);                                             \
        auto r0 = __builtin_amdgcn_permlane32_swap(a0, b0, false, false); auto r1 = __builtin_amdgcn_permlane32_swap(a1, b1, false, false); \
        v4u w = {r0[0], r1[0], r0[1], r1[1]}; OUT = __builtin_bit_cast(bf16x8, w); } while (0)
    PK4(p0, 0, pa0); PK4(p0, 8, pa1); PK4(p1, 0, pa2); PK4(p1, 8, pa3);
#undef PK4
}
__device__ __forceinline__ void attn_phase(const Ctx& C, LAS unsigned char* lds, int G, int vcu, const int wave_s) {
    int tid_ = mytid(wave_s); asm volatile("" : "+v"(tid_)); const int tid = tid_, lane = tid & 63, wid = __builtin_amdgcn_readfirstlane(tid >> 6), r32 = lane & 31, hi = lane >> 5;
    unsigned char* ws = C.ws;
    const bf16* Q = (const bf16*)C.out; const bf16* Kn = (const bf16*)(ws + WS_H); const bf16* KR = (const bf16*)(ws + WS_KR); const bf16* Vb = (const bf16*)(ws + WS_VB);
    bf16* MRG = (bf16*)(ws + WS_U); const bf16* GB = (const bf16*)(ws + WS_GB);
    const int sr = tid >> 4, sc = (tid & 15) * 8, krow = tid >> 3, kc = tid & 7;
    const int vst0 = v_st(sr, sc), vst1 = v_st(32 + sr, sc), kws0 = KSW(sr, sc * 2), kws1 = KSW(32 + sr, sc * 2), kwr = KSW(krow, 256 + kc * 16);
    const int vb0 = (int)(uintptr_t)lds + AT_V + v_rd_base(lane);
    LAS float* wsf = (LAS float*)(lds + AT_WS) + wid * 64; LAS float* li_l = wsf; LAS float* al_l = wsf + 32;
    const unsigned tk = (unsigned)(sr * DM + sc) * 2u, tr = (unsigned)(krow * 64 + kc * 8) * 2u;
    int kof[4];
#pragma unroll
    for (int dd = 0; dd < 4; ++dd) kof[dd] = KSW(r32, dd * 32 + hi * 16);
    for (int item = vcu; item < 512; item += G) {
        const int bh = item >> 2, xq = item & 3, b = bh >> 3, h = bh & 7;
        for (int pass = 0; pass < 2; ++pass) {
            const int qb = pass ? xq : 7 - xq;
            const int q0 = qb * 256, tok0 = b * SEQ + q0, NT = 4 * (qb + 1);
            const int qlo = q0 + wid * 32;
            bf16x8 qr[12];
            { const bf16* qp = Q + (size_t)(tok0 + wid * 32 + r32) * NQ + h * 192 + hi * 8;
#pragma unroll
              for (int d0 = 0; d0 < 12; ++d0) qr[d0] = *(const bf16x8*)(qp + d0 * 16); }
            float m_reg = -1e30f, l_reg = 0.f; f32x16 o[4] = {};
            bf16x8 st_k0, st_k1, st_kr, st_v0, st_v1;
#define ALOAD(kb_) do { const size_t t0_ = (size_t)(b * SEQ + (kb_));                          \
                const char* kB_ = (const char*)(Kn + t0_ * DM + h * 128); const char* vB_ = (const char*)(Vb + t0_ * DM + h * 128); const char* rB_ = (const char*)(KR + t0_ * 64);   \
                st_k0 = *(const bf16x8*)(kB_ + tk); st_k1 = *(const bf16x8*)(kB_ + 32 * DM * 2 + tk);   \
                st_kr = *(const bf16x8*)(rB_ + tr);                                                         \
                st_v0 = *(const bf16x8*)(vB_ + tk); st_v1 = *(const bf16x8*)(vB_ + 32 * DM * 2 + tk); } while (0)
            ALOAD(0);
            for (int t = 0; t < NT; ++t) {
                const int buf = t & 1, kb = t * 64;
                LAS unsigned char* Kb = lds + AT_K + buf * AT_KB; LAS unsigned char* Vbuf = lds + AT_V + buf * AT_VB;
                *(LAS bf16x8*)(Kb + kws0) = st_k0; *(LAS bf16x8*)(Kb + kws1) = st_k1; *(LAS bf16x8*)(Kb + kwr) = st_kr;
                *(LAS bf16x8*)(Vbuf + vst0) = st_v0; *(LAS bf16x8*)(Vbuf + vst1) = st_v1;
                if (t + 1 < NT) ALOAD(kb + 64);
                __syncthreads();
                if (kb <= qlo + 31) {
                    f32x16 p0 = {}, p1 = {};
#pragma unroll
                    for (int d0 = 0; d0 < 12; ++d0) { const LAS unsigned char* a = Kb + kof[d0 & 3] + (d0 >> 2) * 128;
                        const bf16x8 a0 = *(const LAS bf16x8*)a, a1 = *(const LAS bf16x8*)(a + 32 * 384);
                        p0 = __builtin_amdgcn_mfma_f32_32x32x16_bf16(a0, qr[d0], p0, 0, 0, 0);
                        p1 = __builtin_amdgcn_mfma_f32_32x32x16_bf16(a1, qr[d0], p1, 0, 0, 0); }
                    if (kb + 63 > qlo) {
                        const int dq = qlo + r32 - 4 * hi - kb; const float NEG = -__builtin_inff();
#pragma unroll
                        for (int r = 0; r < 16; ++r) { const int c = (r & 3) + 8 * (r >> 2); if (dq - c < 0) p0[r] = NEG; if (dq - c - 32 < 0) p1[r] = NEG; }
                    }
                    float mn, alpha; partialSM(p0, p1, m_reg, mn, alpha);
                    if (__any(alpha < 1.f)) { if (hi == 0) al_l[r32] = alpha; LDS_WAIT();
#pragma unroll
                        for (int r = 0; r < 16; ++r) { const float a = al_l[crow(r, hi)];
#pragma unroll
                            for (int d = 0; d < 4; ++d) o[d][r] *= a; }
                        LDS_WAIT(); }
                    bf16x8 pa0, pa1, pa2, pa3; finishSM(p0, p1, alpha, l_reg, pa0, pa1, pa2, pa3);
                    const int vb = vb0 + buf * AT_VB;
                    pv_d0<0>(o[0], vb, pa0, pa1, pa2, pa3); pv_d0<512>(o[1], vb, pa0, pa1, pa2, pa3); pv_d0<1024>(o[2], vb, pa0, pa1, pa2, pa3); pv_d0<1536>(o[3], vb, pa0, pa1, pa2, pa3);
                }
            }
#undef ALOAD
            if (hi == 0) li_l[r32] = l_reg; LDS_WAIT();
            float rli[16];
#pragma unroll
            for (int r = 0; r < 16; ++r) rli[r] = __builtin_amdgcn_rcpf(li_l[crow(r, hi)]);
            __syncthreads();
            LAS bf16* ost = (LAS bf16*)(lds + wid * 8192);
#pragma unroll
            for (int r = 0; r < 16; ++r) { const int orow = crow(r, hi);
#pragma unroll
                for (int d = 0; d < 4; ++d) { const unsigned w = cvtpk(o[d][r] * rli[r], 0.f); ost[orow * 128 + d * 32 + r32] = (bf16)(w & 0xffffu); } }
            LDS_WAIT();
#pragma unroll
            for (int i = 0; i < 8; ++i) { const int rw = i * 4 + (lane >> 4), cc = (lane & 15) * 8;
                const v4u ow = *(const LAS v4u*)(ost + rw * 128 + cc);
                const size_t off = (size_t)(tok0 + wid * 32 + rw) * DM + h * 128 + cc;
                float ov[8], ma[8], gb[8]; unpack8(ow, ov); unpack8(*(const v4u*)(MRG + off), ma); unpack8(*(const v4u*)(GB + off), gb);
#pragma unroll
                for (int j = 0; j < 8; ++j) ov[j] = ma[j] + gb[j] * ov[j];
                *(v4u*)(MRG + off) = pack8(ov); }
            __syncthreads();
        }
    }
}

struct ConvHalo { v4u g1, g2, v1, v2; };
__device__ __forceinline__ bool conv_item(int gt, int& row0, int& colg, int& chan) {
    if (gt >= 256 * 352) return false;
    const int seg = gt / 352, cg_ = gt - seg * 352, blk = cg_ >> 4, j = cg_ & 15;
    row0 = seg * 128; colg = blk * 256 + j * 8; chan = blk * 128 + j * 8; return true;
}
__device__ __forceinline__ void conv_read_halo(const Ctx& C, int gt, ConvHalo& Hh) {
    const bf16* UP = (const bf16*)(C.ws + WS_UP);
    int row0, colg, chan; const v4u z = {0u, 0u, 0u, 0u}; Hh.g1 = z; Hh.g2 = z; Hh.v1 = z; Hh.v2 = z;
    if (!conv_item(gt, row0, colg, chan)) return;
    if ((row0 & (SEQ - 1)) != 0) {
        Hh.g1 = *(const v4u*)(UP + (size_t)(row0 - 1) * NUP + colg); Hh.g2 = *(const v4u*)(UP + (size_t)(row0 - 2) * NUP + colg);
        Hh.v1 = *(const v4u*)(UP + (size_t)(row0 - 1) * NUP + colg + 128); Hh.v2 = *(const v4u*)(UP + (size_t)(row0 - 2) * NUP + colg + 128);
    }
}
__device__ __forceinline__ void conv_apply(const Ctx& C, int gt, const ConvHalo& Hh) {
    bf16* UP = (bf16*)(C.ws + WS_UP);
    int row0, colg, chan; if (!conv_item(gt, row0, colg, chan)) return;
    const float* cw = C.in[15]; const float* cb = C.in[16];
    float wg[3][8], wv[3][8], bg[8], bv[8];
#pragma unroll
    for (int k = 0; k < 3; ++k)
#pragma unroll
        for (int j = 0; j < 8; ++j) { wg[k][j] = cw[(size_t)k * NUP + chan + j]; wv[k][j] = cw[(size_t)k * NUP + DFF + chan + j]; }
#pragma unroll
    for (int j = 0; j < 8; ++j) { bg[j] = cb[chan + j]; bv[j] = cb[DFF + chan + j]; }
    float g1[8], g2[8], v1[8], v2[8]; unpack8(Hh.g1, g1); unpack8(Hh.g2, g2); unpack8(Hh.v1, v1); unpack8(Hh.v2, v2);
#pragma unroll 4
    for (int r = 0; r < 128; ++r) {
        bf16* p = UP + (size_t)(row0 + r) * NUP + colg;
        float g0[8], v0[8]; unpack8(*(const v4u*)p, g0); unpack8(*(const v4u*)(p + 128), v0);
        float ov[8];
#pragma unroll
        for (int j = 0; j < 8; ++j) { const float yg = bg[j] + wg[0][j] * g2[j] + wg[1][j] * g1[j] + wg[2][j] * g0[j];
            const float yv = bv[j] + wv[0][j] * v2[j] + wv[1][j] * v1[j] + wv[2][j] * v0[j];
            ov[j] = yg * sigm(yg) * yv; g2[j] = g1[j]; g1[j] = g0[j]; v2[j] = v1[j]; v1[j] = v0[j]; }
        *(v4u*)p = pack8(ov);
    }
}

__global__ void __launch_bounds__(512, 2) fwd_megakernel(Ctx C) {
    extern __shared__ __attribute__((aligned(16))) unsigned char lds_raw[];
    LAS unsigned char* lds = (LAS unsigned char*)lds_raw;
    cg::grid_group grid = cg::this_grid();
    const int G = gridDim.x, bx = blockIdx.x;
    const int vcu = (G % 8 == 0) ? (bx % 8) * (G / 8) + bx / 8 : bx;
    unsigned char* ws = C.ws;

    const int wave_s = __builtin_amdgcn_readfirstlane((int)threadIdx.x >> 6);
    p0_prologue(C, lds, G, wave_s);
    grid.sync();
    {
        pg8::Gemm g{(const bf16*)(ws + WS_H), (const bf16*)(ws + WS_WIN)}; pg8::StaticOrder S; S.init(T, NIN, G, bx);
        EpiIn E{ws};
        pg8::gemm_phase<EpiIn, pg8::StaticOrder, true, true, 1024, 1024, 256, 1024>(lds, g, S, E, wave_s);
    }
    grid.sync();
    {
        pg8::Gemm g{(const bf16*)(ws + WS_CQ), (const bf16*)(ws + WS_WUQ)}; pg8::StaticOrder S; S.init(T, NQ, G, bx);
        EpiQ E{(bf16*)C.out, ws};
        pg8::gemm_phase<EpiQ, pg8::StaticOrder, true, true, 256, 256, 256, 256>(lds, g, S, E, wave_s);
    }
    {
        pg8::Gemm g{(const bf16*)(ws + WS_CKV), (const bf16*)(ws + WS_WUKV)}; pg8::StaticOrder S; S.init(T, NKV, G, bx);
        EpiKV E{ws};
        pg8::gemm_phase<EpiKV, pg8::StaticOrder, true, true, 256, 256, 256, 256>(lds, g, S, E, wave_s);
    }
    __syncthreads();
    spatial_phase(C, lds, G, vcu, wave_s);
    grid.sync();
    attn_phase(C, lds, G, vcu, wave_s);
    grid.sync();
    {
        pg8::Gemm g{(const bf16*)(ws + WS_U), (const bf16*)(ws + WS_WOUT)}; pg8::StaticOrder S; S.init(T, DM, G, bx);
        EpiOut E{C.in[0], C.out, ws};
        pg8::gemm_phase<EpiOut, pg8::StaticOrder, true, true, 1024, 1024, 256, 1024>(lds, g, S, E, wave_s);
    }
    grid.sync();
    {
        pg8::Gemm g{(const bf16*)(ws + WS_H), (const bf16*)(ws + WS_WUP)}; pg8::StaticOrder S; S.init(T, NUP, G, bx);
        EpiUp E{ws};
        pg8::gemm_phase<EpiUp, pg8::StaticOrder, true, true, 1024, 1024, 256, 1024>(lds, g, S, E, wave_s);
    }
    grid.sync();
    {
        int tid_ = mytid(wave_s); asm volatile("" : "+v"(tid_)); const int gt = bx * 512 + tid_;
        ConvHalo Hh; conv_read_halo(C, gt, Hh);
        grid.sync();
        conv_apply(C, gt, Hh);
    }
    grid.sync();
    {
        pg8::Gemm g{(const bf16*)(ws + WS_UP), (const bf16*)(ws + WS_WDN)}; pg8::StaticOrder S; S.init(T, DM, G, bx);
        EpiDown E{C.out, ws};
        pg8::gemm_phase<EpiDown, pg8::StaticOrder, true, true, NUP, DFF, 512, DFF>(lds, g, S, E, wave_s);
    }
    grid.sync();
    {
        const float* fn = C.in[18]; const float* ss3 = (const float*)(ws + WS_STAT) + 5 * T;
        int tid_ = mytid(wave_s); asm volatile("" : "+v"(tid_));
        for (size_t i = (size_t)bx * 512 + tid_; i < (size_t)T * DM / 4; i += (size_t)G * 512) {
            const int row = (int)(i >> 8), c4 = (int)(i & 255) * 4;
            const float rinv = 1.0f / sqrtf(ss3[row] * (1.0f / DM) + EPS);
            f32x4 v = *(const f32x4*)(C.out + i * 4); const f32x4 gn = *(const f32x4*)(fn + c4);
            v[0] *= rinv * gn[0]; v[1] *= rinv * gn[1]; v[2] *= rinv * gn[2]; v[3] *= rinv * gn[3];
            *(f32x4*)(C.out + i * 4) = v; }
    }
}

extern "C" void kernel_launch(void* const* d_in, const int* in_sizes, int n_in, void* d_out, int out_size, void* d_ws, size_t ws_size, hipStream_t stream) {
    static int grid_blocks = 0;
    if (grid_blocks == 0) {
        if (n_in != 19 || out_size != T * DM || ws_size < WS_END) { fprintf(stderr, "kernel_launch: unexpected problem geometry (n_in %d out %d ws %zu)\n", n_in, out_size, ws_size); grid_blocks = -1; return; }
        int dev = 0, cus = 0, per_cu = 0;
        (void)hipGetDevice(&dev); (void)hipDeviceGetAttribute(&cus, hipDeviceAttributeMultiprocessorCount, dev);
        if (hipFuncSetAttribute((const void*)fwd_megakernel, hipFuncAttributeMaxDynamicSharedMemorySize, LDS_BYTES) != hipSuccess) { fprintf(stderr, "kernel_launch: hipFuncSetAttribute failed\n"); grid_blocks = -1; return; }
        if (hipOccupancyMaxActiveBlocksPerMultiprocessor(&per_cu, (const void*)fwd_megakernel, 512, LDS_BYTES) != hipSuccess || per_cu < 1) { fprintf(stderr, "kernel_launch: occupancy query gave %d\n", per_cu); per_cu = 1; }
        (void)hipGetLastError();
        grid_blocks = cus * 1;
    }
    if (grid_blocks < 0) return;
    Ctx c{};
    for (int i = 0; i < 19; ++i) c.in[i] = (const float*)d_in[i];
    c.out = (float*)d_out; c.ws = (unsigned char*)d_ws;
    void* args[] = {&c};
    hipError_t e = hipLaunchCooperativeKernel((const void*)fwd_megakernel, dim3(grid_blocks), dim3(512), args, LDS_BYTES, stream);
    if (e != hipSuccess) fprintf(stderr, "cooperative launch failed: %s (grid %d)\n", hipGetErrorString(e), grid_blocks);
}
```
